# Optimizing an MI355X kernel written in HIP

```python
import math
import jax, jax.numpy as jnp
from jax import lax
import numpy as np

D_MODEL = 1024
BATCH = 8
SEQ = 2048
DEPTH = 1
DEC_BATCH = 128
DEC_SEQ = 4
PAST_LEN = 2048
PAGE_SIZE = 128

D_MIX = D_MODEL
W_A = D_MIX // 2
W_B = D_MIX - W_A
HEAD_DIM = 64
N_HEADS = W_A // HEAD_DIM
N_KV = 2
N_IDX_HEADS = 8
IDX_DIM = 64
TOPK_MAX = 256
CHUNK = 128
N_GROUPS_B = 4
GROUP_W_B = W_B // N_GROUPS_B
Q_BLOCK = 128
ROPE_THETA = 10000.0
LN_EPS = 1e-5
ALPHA = (2.0 * DEPTH) ** 0.25
BETA = (8.0 * DEPTH) ** -0.25
NEG = -1e30
SPLITS = (W_A, N_KV * HEAD_DIM, N_KV * HEAD_DIM, W_A, N_IDX_HEADS * IDX_DIM, IDX_DIM, N_IDX_HEADS, W_B, W_B, W_B)
D_IN = W_A * 2 + 2 * N_KV * HEAD_DIM + N_IDX_HEADS * IDX_DIM + IDX_DIM + N_IDX_HEADS + 3 * W_B

kernel_name = "hymba_dsa_gmlp_decode_step"


def layer_norm(x, g, b):
    xf = x.astype(jnp.float32)
    mu = jnp.mean(xf, axis=-1, keepdims=True)
    var = jnp.mean(jnp.square(xf - mu), axis=-1, keepdims=True)
    return ((xf - mu) * lax.rsqrt(var + LN_EPS) * g.astype(jnp.float32) + b.astype(jnp.float32)).astype(x.dtype)


def rope(x, pos):
    half = x.shape[-1] // 2
    inv = ROPE_THETA ** (-jnp.arange(half, dtype=jnp.float32) / half)
    ang = pos.astype(jnp.float32)[:, None] * inv[None, :]
    cos = jnp.cos(ang)[:, None, :]
    sin = jnp.sin(ang)[:, None, :]
    xf = x.astype(jnp.float32)
    x1, x2 = xf[..., :half], xf[..., half:]
    return jnp.concatenate([x1 * cos - x2 * sin, x2 * cos + x1 * sin], axis=-1).astype(x.dtype)


def project(x, w_in, pos):
    z = jnp.einsum('ntd,de->nte', x, w_in)
    cuts, acc = [], 0
    for w in SPLITS[:-1]:
        acc += w
        cuts.append(acc)
    q, k, v, ga, qi, ki, wi, u, vb, gb = jnp.split(z, cuts, axis=-1)
    n, t = x.shape[0], x.shape[1]
    q = rope(q.reshape(n, t, N_HEADS, HEAD_DIM), pos)
    k = rope(k.reshape(n, t, N_KV, HEAD_DIM), pos)
    v = v.reshape(n, t, N_KV, HEAD_DIM)
    qi = rope(qi.reshape(n, t, N_IDX_HEADS, IDX_DIM), pos)
    ki = rope(ki[:, :, None, :], pos)[:, :, 0]
    return q, k, v, ga, qi, ki, wi, u, vb, gb


def indexer_topk(qi, wi, ki, qpos, topk):
    s = jnp.einsum('nqhd,nld->nqhl', qi.astype(jnp.float32), ki.astype(jnp.float32))
    w = wi.astype(jnp.float32) * (N_IDX_HEADS * IDX_DIM) ** -0.5
    score = jnp.einsum('nqhl,nqh->nql', jax.nn.relu(s), w)
    kpos = jnp.arange(ki.shape[1], dtype=jnp.int32)
    allowed = kpos[None, :] <= qpos[:, None]
    score = jnp.where(allowed[None], score, NEG)
    _, idx = lax.top_k(score, topk)
    valid = idx <= qpos[None, :, None]
    return idx, valid


def gather_rows(rows, idx):
    return jax.vmap(lambda r, i: r[i])(rows, idx)


def sparse_attend(q, k_sel, v_sel, valid):
    n, nq = q.shape[0], q.shape[1]
    qg = q.reshape(n, nq, N_KV, N_HEADS // N_KV, HEAD_DIM).astype(jnp.float32)
    s = jnp.einsum('nqhgd,nqkhd->nqhgk', qg, k_sel.astype(jnp.float32)) * HEAD_DIM ** -0.5
    s = jnp.where(valid[:, :, None, None, :], s, NEG)
    p = jax.nn.softmax(s, axis=-1)
    o = jnp.einsum('nqhgk,nqkhd->nqhgd', p, v_sel.astype(jnp.float32))
    return o.reshape(n, nq, W_A).astype(q.dtype)


def chunk_mix(vn, w_s, b_s, t):
    mask = jnp.tril(jnp.ones((t, t), dtype=vn.dtype))
    wm = w_s[:, :t, :t] * mask[None]
    out = jnp.einsum('gts,ncsgd->nctgd', wm, vn)
    return out + jnp.transpose(b_s[:, :t])[:, :, None]


def mixer_out(x, attn, ga, u, mixed, gb, w_out, ln_g, ln_b):
    a_out = attn * jax.nn.silu(ga)
    b_out = u * mixed * jax.nn.silu(gb)
    out = jnp.einsum('nte,ed->ntd', jnp.concatenate([a_out, b_out], axis=-1), w_out)
    return layer_norm(ALPHA * x + out, ln_g, ln_b)


def layer_prompt(x, w_in, w_s, b_s, ln_v_g, ln_v_b, w_out, ln_g, ln_b):
    n = x.shape[0]
    pos = jnp.arange(SEQ, dtype=jnp.int32)
    q, k, v, ga, qi, ki, wi, u, vb, gb = project(x, w_in, pos)
    topk = min(TOPK_MAX, SEQ // 4)
    n_blocks = SEQ // Q_BLOCK

    def block(i):
        start = i * Q_BLOCK
        sl = lambda a: lax.dynamic_slice_in_dim(a, start, Q_BLOCK, axis=1)
        qpos = start + jnp.arange(Q_BLOCK, dtype=jnp.int32)
        idx, valid = indexer_topk(sl(qi), sl(wi), ki, qpos, topk)
        return sparse_attend(sl(q), gather_rows(k, idx), gather_rows(v, idx), valid)

    attn = lax.map(block, jnp.arange(n_blocks, dtype=jnp.int32))
    attn = jnp.transpose(attn, (1, 0, 2, 3)).reshape(n, SEQ, W_A)
    vn = layer_norm(vb, ln_v_g, ln_v_b)
    mixed = chunk_mix(vn.reshape(n, SEQ // CHUNK, CHUNK, N_GROUPS_B, GROUP_W_B), w_s, b_s, CHUNK).reshape(n, SEQ, W_B)
    y = mixer_out(x, attn, ga, u, mixed, gb, w_out, ln_g, ln_b)
    return y, k, v, ki, vn[:, SEQ - CHUNK:]


def layer_sample(x, cache_k, cache_v, cache_k_idx, page_table, w_in, w_s, b_s, ln_v_g, ln_v_b, w_out, ln_g, ln_b):
    n = x.shape[0]
    pos = PAST_LEN + jnp.arange(DEC_SEQ, dtype=jnp.int32)
    q, k, v, ga, qi, ki, wi, u, vb, gb = project(x, w_in, pos)
    total = PAST_LEN + DEC_SEQ
    topk = min(TOPK_MAX, total // 4)
    ki_past = cache_k_idx[page_table].reshape(n, PAST_LEN, IDX_DIM)
    ki_all = jnp.concatenate([ki_past.astype(ki.dtype), ki], axis=1)
    idx, valid = indexer_topk(qi, wi, ki_all, pos, topk)
    is_past = (idx < PAST_LEN)[..., None, None]
    pidx = jnp.minimum(idx, PAST_LEN - 1)
    phys = page_table[jnp.arange(n)[:, None, None], pidx // PAGE_SIZE]
    off = pidx % PAGE_SIZE
    nidx = jnp.clip(idx - PAST_LEN, 0, DEC_SEQ - 1)
    k_sel = jnp.where(is_past, cache_k[phys, off].astype(k.dtype), gather_rows(k, nidx))
    v_sel = jnp.where(is_past, cache_v[phys, off].astype(v.dtype), gather_rows(v, nidx))
    attn = sparse_attend(q, k_sel, v_sel, valid)
    vn = layer_norm(vb, ln_v_g, ln_v_b)
    mixed = chunk_mix(vn.reshape(n, 1, DEC_SEQ, N_GROUPS_B, GROUP_W_B), w_s, b_s, DEC_SEQ).reshape(n, DEC_SEQ, W_B)
    y = mixer_out(x, attn, ga, u, mixed, gb, w_out, ln_g, ln_b)
    return y, k, v, ki, vn


def setup_inputs(seed: int = 0) -> dict:
    key = jax.random.key(seed)
    ks = jax.random.split(key, 16)
    n_pages = PAST_LEN // PAGE_SIZE
    n_pool = (DEC_BATCH * n_pages * 5) // 4
    f32 = jnp.float32
    x_prompt = jax.random.normal(ks[0], (BATCH, SEQ, D_MODEL), f32)
    x_sample = jax.random.normal(ks[1], (DEC_BATCH, DEC_SEQ, D_MODEL), f32)
    cache_k = jax.random.normal(ks[2], (DEPTH, n_pool, PAGE_SIZE, N_KV, HEAD_DIM), f32)
    cache_v = jax.random.normal(ks[3], (DEPTH, n_pool, PAGE_SIZE, N_KV, HEAD_DIM), f32)
    cache_k_idx = jax.random.normal(ks[4], (DEPTH, n_pool, PAGE_SIZE, IDX_DIM), f32)
    perm = jax.random.permutation(ks[5], n_pool)[: DEC_BATCH * n_pages]
    page_table = perm.reshape(DEC_BATCH, n_pages).astype(jnp.int32)
    w_in = jax.random.normal(ks[6], (DEPTH, D_MODEL, D_IN), f32) * D_MODEL ** -0.5
    w_s = jax.random.normal(ks[7], (DEPTH, N_GROUPS_B, CHUNK, CHUNK), f32) * CHUNK ** -0.5
    b_s = 1.0 + 0.01 * jax.random.normal(ks[8], (DEPTH, N_GROUPS_B, CHUNK), f32)
    ln_v_g = 1.0 + 0.01 * jax.random.normal(ks[9], (DEPTH, W_B), f32)
    ln_v_b = 0.01 * jax.random.normal(ks[10], (DEPTH, W_B), f32)
    w_out = jax.random.normal(ks[11], (DEPTH, D_MIX, D_MODEL), f32) * (D_MIX ** -0.5) * BETA
    ln_g = 1.0 + 0.01 * jax.random.normal(ks[12], (DEPTH, D_MODEL), f32)
    ln_b = 0.01 * jax.random.normal(ks[13], (DEPTH, D_MODEL), f32)
    return {"x_prompt": x_prompt, "x_sample": x_sample, "cache_k": cache_k, "cache_v": cache_v,
            "cache_k_idx": cache_k_idx, "page_table": page_table, "w_in": w_in, "w_s": w_s, "b_s": b_s,
            "ln_v_g": ln_v_g, "ln_v_b": ln_v_b, "w_out": w_out, "ln_g": ln_g, "ln_b": ln_b}


def reference(x_prompt, x_sample, cache_k, cache_v, cache_k_idx, page_table, w_in, w_s, b_s, ln_v_g, ln_v_b, w_out, ln_g, ln_b):
    xp, xs = x_prompt, x_sample
    kp, vp, kip, vbp = [], [], [], []
    kss, vss, kis, vbs = [], [], [], []
    for l in range(DEPTH):
        xp, k1, v1, ki1, vb1 = layer_prompt(xp, w_in[l], w_s[l], b_s[l], ln_v_g[l], ln_v_b[l], w_out[l], ln_g[l], ln_b[l])
        xs, k2, v2, ki2, vb2 = layer_sample(xs, cache_k[l], cache_v[l], cache_k_idx[l], page_table,
                                            w_in[l], w_s[l], b_s[l], ln_v_g[l], ln_v_b[l], w_out[l], ln_g[l], ln_b[l])
        kp.append(k1); vp.append(v1); kip.append(ki1); vbp.append(vb1)
        kss.append(k2); vss.append(v2); kis.append(ki2); vbs.append(vb2)
    return (xp, xs, jnp.stack(kp), jnp.stack(vp), jnp.stack(kip), jnp.stack(vbp),
            jnp.stack(kss), jnp.stack(vss), jnp.stack(kis), jnp.stack(vbs))
```

```cpp
#include <hip/hip_runtime.h>
#include <cstdint>
#include <cstdio>

constexpr int D_MODEL = 1024, BATCH = 8, SEQ = 2048, DEC_BATCH = 128, DEC_SEQ = 4, PAST_LEN = 2048, PAGE = 128;
constexpr int W_A = 512, W_B = 512, HD = 64, NH = 8, NKV = 2, NIH = 8, IDX = 64, TOPK = 256, CHUNK = 128, NG = 4, GW = 128;
constexpr int D_IN = 3400;
constexpr int C_Q = 0, C_K = 512, C_V = 640, C_GA = 768, C_QI = 1280, C_KI = 1792, C_WI = 1856, C_U = 1864, C_VB = 2376, C_GB = 2888;
constexpr int MP = BATCH * SEQ;
constexpr int MS = DEC_BATCH * DEC_SEQ;
constexpr int MT = MP + MS;
constexpr int NPAGES = PAST_LEN / PAGE;
constexpr float LN_EPS = 1e-5f;
constexpr float ALPHA = 1.189207115002721f;

constexpr size_t O_YP = 0, O_YS = 16777216, O_KP = 17301504, O_VP = 19398656, O_KIP = 21495808, O_VBP = 22544384,
                 O_KS = 23068672, O_VS = 23134208, O_KIS = 23199744, O_VBS = 23232512;

constexpr size_t MiB = 1u << 20;
constexpr size_t WS_Z = 0;
constexpr size_t WS_QR = 232 * MiB;
constexpr size_t WS_QIR = 268 * MiB;
constexpr size_t WS_KR = 304 * MiB;
constexpr size_t WS_VR = 314 * MiB;
constexpr size_t WS_KIR = 324 * MiB;
constexpr size_t WS_VN = 330 * MiB;
constexpr size_t WS_MASK = 366 * MiB;
constexpr size_t WS_MASKS = 371 * MiB;
constexpr size_t WS_ATT = 372 * MiB;
constexpr size_t WS_MIX = 408 * MiB;
constexpr size_t WS_E = 444 * MiB;
constexpr size_t WS_OUTP = 516 * MiB;
constexpr size_t WS_END = 588 * MiB;

struct P {
    const float* xp; const float* xs; const float* ck; const float* cv; const float* cki; const int* pt;
    const float* w_in; const float* w_s; const float* b_s; const float* lnvg; const float* lnvb; const float* w_out; const float* lng; const float* lnb;
    float* out; unsigned char* ws;
};

__device__ __forceinline__ const float* xrow(const P& p, int row) { return row < MP ? p.xp + (size_t)row * D_MODEL : p.xs + (size_t)(row - MP) * D_MODEL; }
__device__ __forceinline__ int row_pos(int row) { return row < MP ? (row & (SEQ - 1)) : PAST_LEN + ((row - MP) & 3); }

__global__ void __launch_bounds__(256) nk_gemm(P p, const float* Aptr, int lda, int a_is_x, const float* B, int ldb, float* C, int ldc, int M, int N, int K) {
    __shared__ float As[16][64 + 4];
    __shared__ float Bs[16][64 + 4];
    const int tid = threadIdx.x, tx = tid & 15, ty = tid >> 4;
    const int m0 = blockIdx.y * 64, n0 = blockIdx.x * 64;
    float acc[4][4];
#pragma unroll
    for (int i = 0; i < 4; ++i)
#pragma unroll
        for (int j = 0; j < 4; ++j) acc[i][j] = 0.f;
    for (int k0 = 0; k0 < K; k0 += 16) {
        {
            const int r = tid >> 2, kq = (tid & 3) * 4;
            const float* ar = a_is_x ? xrow(p, m0 + r) : Aptr + (size_t)(m0 + r) * lda;
            const float4 v = *(const float4*)(ar + k0 + kq);
            As[kq + 0][r] = v.x; As[kq + 1][r] = v.y; As[kq + 2][r] = v.z; As[kq + 3][r] = v.w;
        }
        {
            const int kk = tid >> 4, nq = (tid & 15) * 4;
#pragma unroll
            for (int j = 0; j < 4; ++j) { const int n = n0 + nq + j; Bs[kk][nq + j] = (n < N) ? B[(size_t)(k0 + kk) * ldb + n] : 0.f; }
        }
        __syncthreads();
#pragma unroll
        for (int kk = 0; kk < 16; ++kk) {
            float a[4], b[4];
#pragma unroll
            for (int i = 0; i < 4; ++i) a[i] = As[kk][ty * 4 + i];
#pragma unroll
            for (int j = 0; j < 4; ++j) b[j] = Bs[kk][tx * 4 + j];
#pragma unroll
            for (int i = 0; i < 4; ++i)
#pragma unroll
                for (int j = 0; j < 4; ++j) acc[i][j] = fmaf(a[i], b[j], acc[i][j]);
        }
        __syncthreads();
    }
#pragma unroll
    for (int i = 0; i < 4; ++i)
#pragma unroll
        for (int j = 0; j < 4; ++j) { const int n = n0 + tx * 4 + j; if (n < N) C[(size_t)(m0 + ty * 4 + i) * ldc + n] = acc[i][j]; }
}

__device__ __forceinline__ float wave_sum(float v) {
#pragma unroll
    for (int o = 1; o < 64; o <<= 1) v += __shfl_xor(v, o);
    return v;
}
__device__ __forceinline__ float wave_max(float v) {
#pragma unroll
    for (int o = 1; o < 64; o <<= 1) v = fmaxf(v, __shfl_xor(v, o));
    return v;
}
__device__ __forceinline__ float wave_min(float v) {
#pragma unroll
    for (int o = 1; o < 64; o <<= 1) v = fminf(v, __shfl_xor(v, o));
    return v;
}
__device__ __forceinline__ float silu(float x) { return x / (1.f + __expf(-x)); }

__device__ __forceinline__ void rope_cs(int pos, int i, float& c, float& s) {
    const float inv = exp2f(-(float)i * (13.287712379549449f / 32.0f));
    const float ang = (float)pos * inv;
    const double a = (double)ang;
    const double k = rint(a * 0.15915494309189535);
    const float r = (float)(a - k * 6.283185307179586);
    c = cosf(r); s = sinf(r);
}

__global__ void __launch_bounds__(256) nk_post(P p) {
    const int row = blockIdx.x, tid = threadIdx.x, pos = row_pos(row);
    const float* z = (const float*)(p.ws + WS_Z) + (size_t)row * D_IN;
    float* QR = (float*)(p.ws + WS_QR) + (size_t)row * 512;
    float* QIR = (float*)(p.ws + WS_QIR) + (size_t)row * 512;
    float* KR = (float*)(p.ws + WS_KR) + (size_t)row * 128;
    float* VR = (float*)(p.ws + WS_VR) + (size_t)row * 128;
    float* KIR = (float*)(p.ws + WS_KIR) + (size_t)row * 64;
    float* ok = row < MP ? p.out + O_KP + (size_t)row * 128 : p.out + O_KS + (size_t)(row - MP) * 128;
    float* ov = row < MP ? p.out + O_VP + (size_t)row * 128 : p.out + O_VS + (size_t)(row - MP) * 128;
    float* oki = row < MP ? p.out + O_KIP + (size_t)row * 64 : p.out + O_KIS + (size_t)(row - MP) * 64;
    for (int e = tid; e < 19 * 32; e += 256) {
        const int hh = e >> 5, i = e & 31;
        int src; float* dst; float* dst2 = nullptr;
        if (hh < 8) { src = C_Q + hh * 64; dst = QR + hh * 64; }
        else if (hh < 10) { src = C_K + (hh - 8) * 64; dst = KR + (hh - 8) * 64; dst2 = ok + (hh - 8) * 64; }
        else if (hh < 18) { src = C_QI + (hh - 10) * 64; dst = QIR + (hh - 10) * 64; }
        else { src = C_KI; dst = KIR; dst2 = oki; }
        float c, s; rope_cs(pos, i, c, s);
        const float x1 = z[src + i], x2 = z[src + 32 + i];
        const float o1 = x1 * c - x2 * s, o2 = x2 * c + x1 * s;
        dst[i] = o1; dst[i + 32] = o2;
        if (dst2) { dst2[i] = o1; dst2[i + 32] = o2; }
    }
    if (tid < 128) { const float v = z[C_V + tid]; VR[tid] = v; ov[tid] = v; }
    __shared__ float red[8];
    const float a0 = z[C_VB + tid], a1 = z[C_VB + 256 + tid];
    float s = wave_sum(a0 + a1);
    if ((tid & 63) == 0) red[tid >> 6] = s;
    __syncthreads();
    const float mean = (red[0] + red[1] + red[2] + red[3]) * (1.f / 512.f);
    const float d0 = a0 - mean, d1 = a1 - mean;
    float q = wave_sum(d0 * d0 + d1 * d1);
    if ((tid & 63) == 0) red[4 + (tid >> 6)] = q;
    __syncthreads();
    const float rstd = rsqrtf((red[4] + red[5] + red[6] + red[7]) * (1.f / 512.f) + LN_EPS);
    float* VN = (float*)(p.ws + WS_VN) + (size_t)row * 512;
    const float v0 = d0 * rstd * p.lnvg[tid] + p.lnvb[tid], v1 = d1 * rstd * p.lnvg[256 + tid] + p.lnvb[256 + tid];
    VN[tid] = v0; VN[256 + tid] = v1;
    if (row < MP) {
        const int t = row & (SEQ - 1), b = row >> 11;
        if (t >= SEQ - CHUNK) { float* o = p.out + O_VBP + ((size_t)b * CHUNK + (t - (SEQ - CHUNK))) * 512; o[tid] = v0; o[256 + tid] = v1; }
    } else { float* o = p.out + O_VBS + (size_t)(row - MP) * 512; o[tid] = v0; o[256 + tid] = v1; }
}

__device__ __forceinline__ unsigned fkey(float f) { const unsigned b = __float_as_uint(f); return b ^ ((b >> 31) ? 0xFFFFFFFFu : 0x80000000u); }
__device__ __forceinline__ float funkey(unsigned u) { return __uint_as_float((u & 0x80000000u) ? (u ^ 0x80000000u) : ~u); }
__device__ __forceinline__ int lane_rank(unsigned long long m) { return __builtin_amdgcn_mbcnt_hi((unsigned)(m >> 32), __builtin_amdgcn_mbcnt_lo((unsigned)m, 0)); }

template <int NR>
__device__ __forceinline__ void wave_select(const float* sc, int n, int lane, unsigned long long* outw) {
    float x[NR];
#pragma unroll
    for (int r = 0; r < NR; ++r) { const int idx = r * 64 + lane; x[r] = (idx < n) ? sc[idx] : -INFINITY; }
    float T = -INFINITY; int m = TOPK;
    if (n > TOPK) {
        float mn = INFINITY, mx = -INFINITY;
#pragma unroll
        for (int r = 0; r < NR; ++r) { const int idx = r * 64 + lane; if (idx < n) { mn = fminf(mn, x[r]); mx = fmaxf(mx, x[r]); } }
        mn = wave_min(mn); mx = wave_max(mx);
        float lo = mn, hi = funkey(fkey(mx) + 1u);
        int c_hi = 0;
        for (int it = 0; it < 64; ++it) {
            const unsigned ulo = fkey(lo), uhi = fkey(hi);
            if (uhi - ulo <= 1u) { T = lo; m = TOPK - c_hi; break; }
            float mid = lo + (hi - lo) * 0.5f;
            if (it >= 14 || !(mid > lo && mid < hi)) mid = funkey(ulo + (uhi - ulo) / 2u);
            int c = 0;
#pragma unroll
            for (int r = 0; r < NR; ++r) c += __popcll(__ballot(x[r] >= mid));
            if (c == TOPK) { T = mid; m = TOPK; break; }
            if (c > TOPK) lo = mid; else { hi = mid; c_hi = c; }
        }
    }
    int m_rem = m;
#pragma unroll
    for (int r = 0; r < NR; ++r) {
        const bool valid = (r * 64 + lane) < n;
        const bool gt = valid && (x[r] > T), eq = valid && (x[r] == T);
        const unsigned long long eqm = __ballot(eq);
        const bool sel = gt || (eq && lane_rank(eqm) < m_rem);
        m_rem -= __popcll(eqm);
        const unsigned long long sm = __ballot(sel);
        if (lane == 0) outw[r] = sm;
    }
}

__global__ void __launch_bounds__(256) nk_indexer(P p) {
    __shared__ float qs[512];
    __shared__ float wsh[8];
    __shared__ float sc[2048];
    const int row = blockIdx.x, tid = threadIdx.x, t = row & (SEQ - 1), b = row >> 11;
    const float* QIR = (const float*)(p.ws + WS_QIR) + (size_t)row * 512;
    qs[tid] = QIR[tid]; qs[256 + tid] = QIR[256 + tid];
    if (tid < 8) wsh[tid] = ((const float*)(p.ws + WS_Z))[(size_t)row * D_IN + C_WI + tid] * 0.044194173824159216f;
    __syncthreads();
    const float* KIR = (const float*)(p.ws + WS_KIR) + (size_t)(b * SEQ) * 64;
    for (int s = tid; s <= t; s += 256) {
        const float* kr = KIR + (size_t)s * 64;
        float acc[8];
#pragma unroll
        for (int h = 0; h < 8; ++h) acc[h] = 0.f;
#pragma unroll 1
        for (int d = 0; d < 64; d += 4) {
            const float4 kv = *(const float4*)(kr + d);
#pragma unroll
            for (int h = 0; h < 8; ++h) acc[h] += qs[h * 64 + d] * kv.x + qs[h * 64 + d + 1] * kv.y + qs[h * 64 + d + 2] * kv.z + qs[h * 64 + d + 3] * kv.w;
        }
        float score = 0.f;
#pragma unroll
        for (int h = 0; h < 8; ++h) score += fmaxf(acc[h], 0.f) * wsh[h];
        sc[s] = score;
    }
    __syncthreads();
    if (tid < 64) wave_select<32>(sc, t + 1, tid, (unsigned long long*)(p.ws + WS_MASK) + (size_t)row * 32);
}

__global__ void __launch_bounds__(256) ns_indexer(P p) {
    __shared__ float qs[512];
    __shared__ float wsh[8];
    __shared__ float sc[2112];
    const int r = blockIdx.x, tid = threadIdx.x, n = r >> 2, j = r & 3, row = MP + r;
    const float* QIR = (const float*)(p.ws + WS_QIR) + (size_t)row * 512;
    qs[tid] = QIR[tid]; qs[256 + tid] = QIR[256 + tid];
    if (tid < 8) wsh[tid] = ((const float*)(p.ws + WS_Z))[(size_t)row * D_IN + C_WI + tid] * 0.044194173824159216f;
    __syncthreads();
    const int nvalid = PAST_LEN + j + 1;
    for (int s = tid; s < nvalid; s += 256) {
        const float* kr;
        if (s < PAST_LEN) { const int pg = p.pt[n * NPAGES + (s >> 7)]; kr = p.cki + ((size_t)pg * PAGE + (s & 127)) * 64; }
        else kr = (const float*)(p.ws + WS_KIR) + (size_t)(MP + n * 4 + (s - PAST_LEN)) * 64;
        float acc[8];
#pragma unroll
        for (int h = 0; h < 8; ++h) acc[h] = 0.f;
#pragma unroll 1
        for (int d = 0; d < 64; d += 4) {
            const float4 kv = *(const float4*)(kr + d);
#pragma unroll
            for (int h = 0; h < 8; ++h) acc[h] += qs[h * 64 + d] * kv.x + qs[h * 64 + d + 1] * kv.y + qs[h * 64 + d + 2] * kv.z + qs[h * 64 + d + 3] * kv.w;
        }
        float score = 0.f;
#pragma unroll
        for (int h = 0; h < 8; ++h) score += fmaxf(acc[h], 0.f) * wsh[h];
        sc[s] = score;
    }
    __syncthreads();
    if (tid < 64) wave_select<33>(sc, nvalid, tid, (unsigned long long*)(p.ws + WS_MASKS) + (size_t)r * 40);
}

__global__ void __launch_bounds__(256) nk_attn(P p, int mode) {
    __shared__ int sel[TOPK];
    __shared__ int nsel_s;
    __shared__ float sbuf[4][TOPK];
    const int tid = threadIdx.x, lane = tid & 63, w = tid >> 6;
    const int row = mode == 0 ? blockIdx.x : MP + blockIdx.x;
    const int nwords = mode == 0 ? 32 : 33;
    const unsigned long long* mw = mode == 0 ? (const unsigned long long*)(p.ws + WS_MASK) + (size_t)row * 32 : (const unsigned long long*)(p.ws + WS_MASKS) + (size_t)(row - MP) * 40;
    if (w == 0) {
        int cnt = 0;
        for (int r = 0; r < nwords; ++r) {
            const unsigned long long m = mw[r];
            if (((m >> lane) & 1ull) && cnt + lane_rank(m) < TOPK) sel[cnt + lane_rank(m)] = r * 64 + lane;
            cnt += __popcll(m);
        }
        if (lane == 0) nsel_s = cnt < TOPK ? cnt : TOPK;
    }
    __syncthreads();
    const int nsel = nsel_s;
    const float* QR = (const float*)(p.ws + WS_QR) + (size_t)row * 512;
    const float* KR = (const float*)(p.ws + WS_KR);
    const float* VR = (const float*)(p.ws + WS_VR);
    float* ATT = (float*)(p.ws + WS_ATT) + (size_t)row * 512;
    const int b = row >> 11, nseq = (row - MP) >> 2;
    for (int hh = 0; hh < 2; ++hh) {
        const int h = 2 * w + hh, kvh = h >> 2;
        const float qd = QR[h * 64 + lane] * 0.125f;
        float mxv = -INFINITY;
        for (int i = 0; i < nsel; ++i) {
            const int s = sel[i];
            const float* kr;
            if (mode == 0) kr = KR + (size_t)(b * SEQ + s) * 128;
            else if (s < PAST_LEN) { const int pg = p.pt[nseq * NPAGES + (s >> 7)]; kr = p.ck + ((size_t)pg * PAGE + (s & 127)) * 128; }
            else kr = KR + (size_t)(MP + nseq * 4 + (s - PAST_LEN)) * 128;
            const float sv = wave_sum(qd * kr[kvh * 64 + lane]);
            if (lane == 0) sbuf[w][i] = sv;
            mxv = fmaxf(mxv, sv);
        }
        __builtin_amdgcn_s_waitcnt(0);
        float o = 0.f, l = 0.f;
        for (int i = 0; i < nsel; ++i) {
            const int s = sel[i];
            const float* vr;
            if (mode == 0) vr = VR + (size_t)(b * SEQ + s) * 128;
            else if (s < PAST_LEN) { const int pg = p.pt[nseq * NPAGES + (s >> 7)]; vr = p.cv + ((size_t)pg * PAGE + (s & 127)) * 128; }
            else vr = VR + (size_t)(MP + nseq * 4 + (s - PAST_LEN)) * 128;
            const float pe = __expf(sbuf[w][i] - mxv);
            l += pe; o += pe * vr[kvh * 64 + lane];
        }
        ATT[h * 64 + lane] = o / l;
    }
}

__global__ void __launch_bounds__(512) nk_mix(P p) {
    const int row = blockIdx.x, col = threadIdx.x, g = col >> 7;
    const float* VN = (const float*)(p.ws + WS_VN);
    int t, base;
    if (row < MP) { t = row & (CHUNK - 1); base = row - t; } else { t = (row - MP) & 3; base = row - t; }
    float acc = p.b_s[g * CHUNK + t];
    const float* wr = p.w_s + ((size_t)g * CHUNK + t) * CHUNK;
    for (int s = 0; s <= t; ++s) acc += wr[s] * VN[(size_t)(base + s) * 512 + col];
    const float* z = (const float*)(p.ws + WS_Z) + (size_t)row * D_IN;
    float* E = (float*)(p.ws + WS_E) + (size_t)row * 1024;
    const float* ATT = (const float*)(p.ws + WS_ATT) + (size_t)row * 512;
    E[col] = ATT[col] * silu(z[C_GA + col]);
    E[512 + col] = z[C_U + col] * acc * silu(z[C_GB + col]);
}

__global__ void __launch_bounds__(256) nk_lnout(P p) {
    __shared__ float red[8];
    const int row = blockIdx.x, tid = threadIdx.x;
    const float* x = xrow(p, row);
    const float* o = (const float*)(p.ws + WS_OUTP) + (size_t)row * 1024;
    float v[4]; float s = 0.f;
#pragma unroll
    for (int j = 0; j < 4; ++j) { v[j] = ALPHA * x[j * 256 + tid] + o[j * 256 + tid]; s += v[j]; }
    s = wave_sum(s);
    if ((tid & 63) == 0) red[tid >> 6] = s;
    __syncthreads();
    const float mean = (red[0] + red[1] + red[2] + red[3]) * (1.f / 1024.f);
    float q = 0.f;
#pragma unroll
    for (int j = 0; j < 4; ++j) { v[j] -= mean; q += v[j] * v[j]; }
    q = wave_sum(q);
    if ((tid & 63) == 0) red[4 + (tid >> 6)] = q;
    __syncthreads();
    const float rstd = rsqrtf((red[4] + red[5] + red[6] + red[7]) * (1.f / 1024.f) + LN_EPS);
    float* y = row < MP ? p.out + O_YP + (size_t)row * 1024 : p.out + O_YS + (size_t)(row - MP) * 1024;
#pragma unroll
    for (int j = 0; j < 4; ++j) y[j * 256 + tid] = v[j] * rstd * p.lng[j * 256 + tid] + p.lnb[j * 256 + tid];
}

extern "C" void kernel_launch(void* const* d_in, const int* in_sizes, int n_in, void* d_out, int out_size, void* d_ws, size_t ws_size, hipStream_t stream) {
    if (ws_size < WS_END) { fprintf(stderr, "kernel_launch: workspace too small (%zu < %zu)\n", ws_size, (size_t)WS_END); return; }
    P p{};
    p.xp = (const float*)d_in[0]; p.xs = (const float*)d_in[1]; p.ck = (const float*)d_in[2]; p.cv = (const float*)d_in[3]; p.cki = (const float*)d_in[4];
    p.pt = (const int*)d_in[5]; p.w_in = (const float*)d_in[6]; p.w_s = (const float*)d_in[7]; p.b_s = (const float*)d_in[8]; p.lnvg = (const float*)d_in[9];
    p.lnvb = (const float*)d_in[10]; p.w_out = (const float*)d_in[11]; p.lng = (const float*)d_in[12]; p.lnb = (const float*)d_in[13];
    p.out = (float*)d_out; p.ws = (unsigned char*)d_ws;
    float* Z = (float*)(p.ws + WS_Z); float* E = (float*)(p.ws + WS_E); float* OUTP = (float*)(p.ws + WS_OUTP);
    nk_gemm<<<dim3((D_IN + 63) / 64, MT / 64), 256, 0, stream>>>(p, nullptr, 0, 1, p.w_in, D_IN, Z, D_IN, MT, D_IN, D_MODEL);
    nk_post<<<MT, 256, 0, stream>>>(p);
    nk_indexer<<<MP, 256, 0, stream>>>(p);
    ns_indexer<<<MS, 256, 0, stream>>>(p);
    nk_attn<<<MP, 256, 0, stream>>>(p, 0);
    nk_attn<<<MS, 256, 0, stream>>>(p, 1);
    nk_mix<<<MT, 512, 0, stream>>>(p);
    nk_gemm<<<dim3(1024 / 64, MT / 64), 256, 0, stream>>>(p, E, 1024, 0, p.w_out, 1024, OUTP, 1024, MT, 1024, 1024);
    nk_lnout<<<MT, 256, 0, stream>>>(p);
}
```
